# Optimizing an MI355X kernel written in HIP

```python
import math
import jax, jax.numpy as jnp
from jax import lax
import numpy as np

D_MODEL = 1024
BATCH = 32
SEQ = 256
DEPTH = 1
DEC_BATCH = 2
DEC_SEQ = 4096
PAST_LEN = 256

GRID_W = 64
D_MIX = D_MODEL
N_HEADS_A = 4
HEAD_DIM_A = 64
V_DIM_A = 2 * HEAD_DIM_A
D_ATTN = N_HEADS_A * V_DIM_A
D_RG = D_MIX - D_ATTN
RG_BLOCKS = 8
RG_BLOCK_W = D_RG // RG_BLOCKS
RG_C = 8.0
CONV_W = 4
CONV_PAD_LEFT = 2
D_FF = 2816
N_MOD = 9
D_IN = 3 * D_ATTN + 2 * D_RG
ROPE_BASE = 10000.0
QBLOCK = 128
EPS = 1e-6

kernel_name = 'hymba_diffattn_rglru_macaron_dit_step'


def _rmsnorm(x, g):
    xf = x.astype(jnp.float32)
    y = xf * lax.rsqrt(jnp.mean(xf * xf, axis=-1, keepdims=True) + EPS)
    return (y * g.astype(jnp.float32)).astype(x.dtype)


def _swiglu(h, w_gate, w_up, w_down):
    return (jax.nn.silu(h @ w_gate) * (h @ w_up)) @ w_down


def _rope_2d(x):
    S = x.shape[1]
    rows = S // GRID_W
    row = jnp.repeat(jnp.arange(rows), GRID_W)
    col = jnp.tile(jnp.arange(GRID_W), rows)
    n_freq = HEAD_DIM_A // 4
    inv_freq = ROPE_BASE ** (-jnp.arange(n_freq, dtype=jnp.float32) / n_freq)

    def rot(xh, pos):
        ang = pos.astype(jnp.float32)[:, None] * inv_freq[None, :]
        cos = jnp.cos(ang)[None, :, None, None, :].astype(x.dtype)
        sin = jnp.sin(ang)[None, :, None, None, :].astype(x.dtype)
        x1, x2 = xh[..., :n_freq], xh[..., n_freq:]
        return jnp.concatenate([x1 * cos - x2 * sin, x1 * sin + x2 * cos], axis=-1)

    half = HEAD_DIM_A // 2
    return jnp.concatenate([rot(x[..., :half], row), rot(x[..., half:], col)], axis=-1)


def _diff_attention(q, k, v, lam):
    B, Sq = q.shape[0], q.shape[1]
    nblk = Sq // QBLOCK
    scale = HEAD_DIM_A ** -0.5
    qb = jnp.moveaxis(q.reshape(B, nblk, QBLOCK, N_HEADS_A, 2, HEAD_DIM_A), 1, 0)

    def block(qi):
        s = jnp.einsum('bqhmd,bkhmd->bhmqk', qi, k, preferred_element_type=jnp.float32) * scale
        p = jax.nn.softmax(s, axis=-1)
        pd = p[:, :, 0] - lam * p[:, :, 1]
        return jnp.einsum('bhqk,bkhv->bqhv', pd.astype(v.dtype), v)

    o = lax.map(block, qb)
    return jnp.moveaxis(o, 0, 1).reshape(B, Sq, N_HEADS_A, V_DIM_A)


def _dwconv(x, w, b):
    S = x.shape[1]
    xp = jnp.pad(x, ((0, 0), (CONV_PAD_LEFT, CONV_W - 1 - CONV_PAD_LEFT), (0, 0)))
    return sum(xp[:, j:j + S] * w[j] for j in range(CONV_W)) + b


def _combine(e1, e2):
    a1, b1 = e1
    a2, b2 = e2
    return a1 * a2, a2 * b1 + b2


def _rglru_dir(xc, w_r, b_r, w_i, b_i, lam, h0, reverse):
    B, S, _ = xc.shape
    xf = xc.astype(jnp.float32)
    xblk = xf.reshape(B, S, RG_BLOCKS, RG_BLOCK_W)
    r = jax.nn.sigmoid(jnp.einsum('bsnc,ncd->bsnd', xblk, w_r.astype(jnp.float32)).reshape(B, S, D_RG) + b_r.astype(jnp.float32))
    i = jax.nn.sigmoid(jnp.einsum('bsnc,ncd->bsnd', xblk, w_i.astype(jnp.float32)).reshape(B, S, D_RG) + b_i.astype(jnp.float32))
    log_a = -RG_C * r * jax.nn.softplus(-lam.astype(jnp.float32))
    a = jnp.exp(log_a)
    bx = jnp.sqrt(-jnp.expm1(2.0 * log_a)) * (i * xf)
    h0 = h0.astype(jnp.float32)
    if reverse:
        bx = bx.at[:, -1].add(a[:, -1] * h0)
    else:
        bx = bx.at[:, 0].add(a[:, 0] * h0)
    _, h = lax.associative_scan(_combine, (a, bx), reverse=reverse, axis=1)
    h_last = h[:, 0] if reverse else h[:, -1]
    return h, h_last


def _rglru(xr, xg, p, l, h0):
    xc = _dwconv(xr, p['conv_w'][l], p['conv_b'][l])
    hf, hf_last = _rglru_dir(xc, p['rg_w_r'][l, 0], p['rg_b_r'][l, 0], p['rg_w_i'][l, 0], p['rg_b_i'][l, 0], p['rg_lambda'][l, 0], h0[:, 0], False)
    hb, hb_last = _rglru_dir(xc, p['rg_w_r'][l, 1], p['rg_b_r'][l, 1], p['rg_w_i'][l, 1], p['rg_b_i'][l, 1], p['rg_lambda'][l, 1], h0[:, 1], True)
    y = ((hf + hb) * jax.nn.gelu(xg.astype(jnp.float32))).astype(xr.dtype)
    return y, jnp.stack([hf_last, hb_last], axis=1).astype(xr.dtype)


def _layer(x, c, p, l, ctx):
    B, S, _ = x.shape
    mod = jax.nn.silu(c) @ p['w_mod'][l] + p['b_mod'][l]
    mod = mod.reshape((-1, 1, N_MOD * D_MODEL))
    sh1, sc1, g1, sh2, sc2, g2, sh3, sc3, g3 = jnp.split(mod, N_MOD, axis=-1)
    ng = p['norm_g'][l]
    h = _rmsnorm(x, ng[0]) * (1.0 + sc1) + sh1
    x = x + g1 * 0.5 * _swiglu(h, p['ffn_w_gate'][l, 0], p['ffn_w_up'][l, 0], p['ffn_w_down'][l, 0])
    h = _rmsnorm(x, ng[1]) * (1.0 + sc2) + sh2
    proj = h @ p['w_in'][l]
    q, k, v, xr, xg = jnp.split(proj, [D_ATTN, 2 * D_ATTN, 3 * D_ATTN, 3 * D_ATTN + D_RG], axis=-1)
    q = q.reshape(B, S, N_HEADS_A, 2, HEAD_DIM_A)
    k = k.reshape(B, S, N_HEADS_A, 2, HEAD_DIM_A)
    v = v.reshape(B, S, N_HEADS_A, V_DIM_A)
    lp = p['diff_lambda'][l].astype(jnp.float32)
    lam_init = 0.8 - 0.6 * math.exp(-0.3 * l)
    lam = jnp.exp(jnp.sum(lp[0] * lp[1])) - jnp.exp(jnp.sum(lp[2] * lp[3])) + lam_init
    if ctx is None:
        k_all, v_all = k, v
        h0 = jnp.zeros((B, 2, D_RG), jnp.float32)
    else:
        k_ctx, v_ctx, h0 = ctx
        q = _rope_2d(q)
        k = _rope_2d(k)
        k_all = jnp.concatenate([k, k_ctx.reshape(B, -1, N_HEADS_A, 2, HEAD_DIM_A).astype(k.dtype)], axis=1)
        v_all = jnp.concatenate([v, v_ctx.astype(v.dtype)], axis=1)
    o = _diff_attention(q, k_all, v_all, lam)
    o = _rmsnorm(o, p['subln_g'][l]) * (1.0 - lam_init)
    rg, h_last = _rglru(xr, xg, p, l, h0)
    mix = jnp.concatenate([o.reshape(B, S, D_ATTN), rg], axis=-1) @ p['w_out'][l]
    x = x + g2 * mix
    h = _rmsnorm(x, ng[2]) * (1.0 + sc3) + sh3
    x = x + g3 * 0.5 * _swiglu(h, p['ffn_w_gate'][l, 1], p['ffn_w_up'][l, 1], p['ffn_w_down'][l, 1])
    return x, k.reshape(B, S, N_HEADS_A, 2 * HEAD_DIM_A), v, h_last


def setup_inputs(seed: int = 0) -> dict:
    key = jax.random.key(seed)
    ks = jax.random.split(key, 32)
    f32 = jnp.float32
    nrm = lambda kk, shape, s: jax.random.normal(kk, shape, f32) * s
    a0 = jax.random.uniform(ks[24], (DEPTH, 2, D_RG), f32, 0.9, 0.999)
    return {
        'x_prompt': nrm(ks[0], (BATCH, SEQ, D_MODEL), 1.0),
        'x_sample': nrm(ks[1], (DEC_BATCH, DEC_SEQ, D_MODEL), 1.0),
        'cache_attn_k': nrm(ks[2], (DEC_BATCH, DEPTH, PAST_LEN, N_HEADS_A, 2 * HEAD_DIM_A), 1.0),
        'cache_attn_v': nrm(ks[3], (DEC_BATCH, DEPTH, PAST_LEN, N_HEADS_A, V_DIM_A), 1.0),
        'state_rglru': nrm(ks[4], (DEC_BATCH, DEPTH, 2, D_RG), 0.5),
        'c': nrm(ks[5], (DEC_BATCH, D_MODEL), 1.0),
        'c_ctx': nrm(ks[6], (D_MODEL,), 1.0),
        'norm_g': 1.0 + nrm(ks[7], (DEPTH, 3, D_MODEL), 0.01),
        'w_mod': nrm(ks[8], (DEPTH, D_MODEL, N_MOD * D_MODEL), D_MODEL ** -0.5),
        'b_mod': nrm(ks[9], (DEPTH, N_MOD * D_MODEL), 0.01),
        'ffn_w_gate': nrm(ks[10], (DEPTH, 2, D_MODEL, D_FF), D_MODEL ** -0.5),
        'ffn_w_up': nrm(ks[11], (DEPTH, 2, D_MODEL, D_FF), D_MODEL ** -0.5),
        'ffn_w_down': nrm(ks[12], (DEPTH, 2, D_FF, D_MODEL), D_FF ** -0.5),
        'w_in': nrm(ks[13], (DEPTH, D_MODEL, D_IN), D_MODEL ** -0.5),
        'w_out': nrm(ks[14], (DEPTH, D_MIX, D_MODEL), D_MIX ** -0.5),
        'diff_lambda': nrm(ks[15], (DEPTH, 4, HEAD_DIM_A), 0.1),
        'subln_g': 1.0 + nrm(ks[16], (DEPTH, V_DIM_A), 0.01),
        'conv_w': nrm(ks[17], (DEPTH, CONV_W, D_RG), CONV_W ** -0.5),
        'conv_b': nrm(ks[18], (DEPTH, D_RG), 0.01),
        'rg_w_r': nrm(ks[19], (DEPTH, 2, RG_BLOCKS, RG_BLOCK_W, RG_BLOCK_W), RG_BLOCK_W ** -0.5),
        'rg_b_r': nrm(ks[20], (DEPTH, 2, D_RG), 0.01),
        'rg_w_i': nrm(ks[21], (DEPTH, 2, RG_BLOCKS, RG_BLOCK_W, RG_BLOCK_W), RG_BLOCK_W ** -0.5),
        'rg_b_i': nrm(ks[22], (DEPTH, 2, D_RG), 0.01),
        'rg_lambda': jnp.log(a0) - jnp.log1p(-a0),
        'final_g': 1.0 + nrm(ks[23], (D_MODEL,), 0.01),
    }


def reference(x_prompt, x_sample, cache_attn_k, cache_attn_v, state_rglru, c, c_ctx,
              norm_g, w_mod, b_mod, ffn_w_gate, ffn_w_up, ffn_w_down, w_in, w_out,
              diff_lambda, subln_g, conv_w, conv_b, rg_w_r, rg_b_r, rg_w_i, rg_b_i,
              rg_lambda, final_g):
    p = dict(norm_g=norm_g, w_mod=w_mod, b_mod=b_mod, ffn_w_gate=ffn_w_gate, ffn_w_up=ffn_w_up,
             ffn_w_down=ffn_w_down, w_in=w_in, w_out=w_out, diff_lambda=diff_lambda,
             subln_g=subln_g, conv_w=conv_w, conv_b=conv_b, rg_w_r=rg_w_r, rg_b_r=rg_b_r,
             rg_w_i=rg_w_i, rg_b_i=rg_b_i, rg_lambda=rg_lambda)
    xp = x_prompt
    k_list, v_list, h_list = [], [], []
    for l in range(DEPTH):
        xp, k_l, v_l, h_l = _layer(xp, c_ctx, p, l, None)
        k_list.append(k_l)
        v_list.append(v_l)
        h_list.append(h_l)
    y_prompt = _rmsnorm(xp, final_g)
    new_cache_attn_k = jnp.stack(k_list, axis=1)
    new_cache_attn_v = jnp.stack(v_list, axis=1)
    new_state_rglru = jnp.stack(h_list, axis=1)
    xs = x_sample
    for l in range(DEPTH):
        xs, _, _, _ = _layer(xs, c, p, l, (cache_attn_k[:, l], cache_attn_v[:, l], state_rglru[:, l]))
    y_sample = _rmsnorm(xs, final_g)
    return (y_prompt, y_sample, new_cache_attn_k, new_cache_attn_v, new_state_rglru)
```

```cpp
#include <hip/hip_runtime.h>
#include <hip/hip_bf16.h>
#include <cstdio>
#include <cstdint>
#include <cmath>
namespace pg8 {
#define PG8_LAS __attribute__((address_space(3)))
typedef unsigned short bf16_t;
typedef short bf16x8 __attribute__((ext_vector_type(8)));
typedef float f32x4 __attribute__((ext_vector_type(4)));
typedef unsigned u32x4 __attribute__((ext_vector_type(4)));
constexpr int BM = 256, BK = 64, HALF = 128, HTB = HALF * BK * 2  , STAGE_BYTES = 8 * HTB, NXCD = 8, WGM = 8;

__host__ __device__ __forceinline__ int lds_byte(int r, int c) { const int st = (r >> 4) * 2 + (c >> 5), rr = r & 15, cc = c & 31, ob = rr * 64 + cc * 2; return st * 1024 + (ob ^ (((ob >> 9) & 1) << 5)); }
__host__ __device__ __forceinline__ void stage_rc(int b, int& R, int& C) { const int st = b / 1024, sb = b % 1024, swz = sb ^ (((sb >> 9) & 1) << 5); R = (st >> 1) * 16 + swz / 64; C = (st & 1) * 32 + (swz % 64) / 2; }
__host__ __device__ __forceinline__ int perm32(int rho) { const int n = rho >> 4, i = rho & 15; return 8 * (i >> 2) + 4 * n + (i & 3); }

struct Unit { int pm, pn; };
struct Gemm { const bf16_t* A; const bf16_t* Bt; int M, N, K; };

struct StaticOrder {
    int nM, nN, nwg, G, c;
    __host__ __device__ void init(int M, int N, int G_, int c_) { nM = M / BM; nN = N / BM; nwg = nM * nN; G = G_; c = c_; }
    __host__ __device__ bool next(int i, Unit& u) const {
        const long L = (long)i * G + c; if (L >= nwg) return false;
        int wgid = (int)L; { const int q = nwg / NXCD, r = nwg % NXCD, xcd = wgid % NXCD, off = wgid / NXCD; wgid = (xcd < r ? xcd * (q + 1) : r * (q + 1) + (xcd - r) * q) + off; }
        const int nig = WGM * nN, gid = wgid / nig, fm = gid * WGM, gsz = (nM - fm) < WGM ? (nM - fm) : WGM;
        u.pm = fm + ((wgid % nig) % gsz); u.pn = (wgid % nig) / gsz; return true;
    }
    __device__ __forceinline__ void a_ready(const Unit&) const {}
    __device__ __forceinline__ void done(const Unit&) const {}
};

__device__ __forceinline__ unsigned cvt_pk_bf16(float lo, float hi) { unsigned r; asm volatile("v_cvt_pk_bf16_f32 %0, %1, %2" : "=v"(r) : "v"(lo), "v"(hi)); return r; }
typedef float f32x2 __attribute__((ext_vector_type(2)));
template <class Epi, class Sched, bool ALIGN_EPI = false, bool SP2 = false>
__device__ __forceinline__ void gemm_phase(PG8_LAS unsigned char* lds, const Gemm g, const Sched& S, const Epi& E) {
    const int tid = threadIdx.x, wid = __builtin_amdgcn_readfirstlane(tid >> 6), lane = tid & 63, wr = wid >> 2, wc = wid & 3, fr = lane & 15, fq = lane >> 4;
    const int K = g.K, nt = K / BK;
    unsigned voffA[2], voffB[2];
#pragma unroll
    for (int i = 0; i < 2; ++i) { int R, C; stage_rc(tid * 16 + i * 8192, R, C); const int Rb = Epi::PERM ? ((R & ~31) + perm32(R & 31)) : R;
        voffA[i] = (unsigned)(R * K + C) * 2u; voffB[i] = (unsigned)(Rb * K + C) * 2u; }
    const size_t kstep = (size_t)(BK * 2);
    const size_t hstep = (size_t)HALF * K * 2;
    const size_t tstep = 2 * hstep;
    const unsigned ldsw = (unsigned)wid * 1024u;
    const int aoff = lds_byte(wr * 64 + fr, fq * 8), boff = lds_byte(wc * 32 + fr, fq * 8);
#define PG8_SA(b, h) (((b) * 2 + (h)) * HTB)
#define PG8_SB(b, h) ((4 + (b) * 2 + (h)) * HTB)
#define PG8_STAGE(bufoff, gbase, voff) do { _Pragma("unroll") for (int _i = 0; _i < 2; ++_i) \
        __builtin_amdgcn_global_load_lds((const unsigned*)((const char*)(gbase) + (voff)[_i]), (PG8_LAS unsigned*)(lds + (bufoff) + ldsw + _i * 8192), 16, 0, 0); } while (0)
#define PG8_LDA(dst, b, h) do { _Pragma("unroll") for (int m = 0; m < 4; ++m) _Pragma("unroll") for (int k = 0; k < 2; ++k) dst[m][k] = *(const PG8_LAS bf16x8*)(lds + PG8_SA(b, h) + aoff + m * 2048 + k * 1024); } while (0)
#define PG8_LDB(dst, b, h) do { _Pragma("unroll") for (int n = 0; n < 2; ++n) _Pragma("unroll") for (int k = 0; k < 2; ++k) dst[n][k] = *(const PG8_LAS bf16x8*)(lds + PG8_SB(b, h) + boff + n * 2048 + k * 1024); } while (0)
#define PG8_MMA(ai, bj, At, Bt) do { __builtin_amdgcn_s_setprio(1); _Pragma("unroll") for (int m = 0; m < 4; ++m) _Pragma("unroll") for (int n = 0; n < 2; ++n) _Pragma("unroll") for (int k = 0; k < 2; ++k) \
        acc[ai][bj][m][n] = __builtin_amdgcn_mfma_f32_16x16x32_bf16(Bt[n][k], At[m][k], acc[ai][bj][m][n], 0, 0, 0); __builtin_amdgcn_s_setprio(0); } while (0)
#define PG8_WAIT_V(n) asm volatile("s_waitcnt vmcnt(" #n ")" ::: "memory")
#define PG8_WAIT_L(n) asm volatile("s_waitcnt lgkmcnt(" #n ")" ::: "memory")
#define PG8_BAR __builtin_amdgcn_s_barrier()
#define PG8_SCHED __builtin_amdgcn_sched_barrier(0)
    Unit cur, nxt; int ui = 0;
    if (!S.next(0, cur)) return;
    f32x4 acc[2][2][4][2];
#pragma unroll
    for (int a = 0; a < 2; ++a)
#pragma unroll
        for (int b = 0; b < 2; ++b)
#pragma unroll
            for (int m = 0; m < 4; ++m)
#pragma unroll
                for (int n = 0; n < 2; ++n) acc[a][b][m][n] = (f32x4){0.f, 0.f, 0.f, 0.f};
    bf16x8 At[4][2], B0[2][2], B1[2][2];
    const char* cA = (const char*)g.A + (size_t)cur.pm * tstep; const char* cB = (const char*)g.Bt + (size_t)cur.pn * tstep;
    S.a_ready(cur);
    if constexpr (SP2) {
        PG8_STAGE(PG8_SB(0, 0), cB, voffB); PG8_STAGE(PG8_SB(0, 1), cB + hstep, voffB); PG8_STAGE(PG8_SA(0, 0), cA, voffA); PG8_STAGE(PG8_SA(0, 1), cA + hstep, voffA);
        if (wr == 1) PG8_BAR;
        PG8_WAIT_V(2); PG8_BAR;
        PG8_STAGE(PG8_SB(1, 0), cB + kstep, voffB); PG8_STAGE(PG8_SA(1, 0), cA + kstep, voffA); PG8_STAGE(PG8_SB(1, 1), cB + hstep + kstep, voffB);
        PG8_WAIT_V(6); PG8_BAR;
    } else {
        PG8_STAGE(PG8_SB(0, 0), cB, voffB); PG8_STAGE(PG8_SA(0, 0), cA, voffA); PG8_STAGE(PG8_SB(0, 1), cB + hstep, voffB); PG8_STAGE(PG8_SA(0, 1), cA + hstep, voffA);
        if (wr == 1) PG8_BAR;
        PG8_WAIT_V(4); PG8_BAR;
        PG8_STAGE(PG8_SB(1, 0), cB + kstep, voffB); PG8_STAGE(PG8_SA(1, 0), cA + kstep, voffA); PG8_STAGE(PG8_SB(1, 1), cB + hstep + kstep, voffB);
        PG8_WAIT_V(6); PG8_BAR;
    }
    for (;;) {
        const bool has_next = S.next(ui + 1, nxt);
        const char* nA = has_next ? (const char*)g.A + (size_t)nxt.pm * tstep : cA; const char* nB = has_next ? (const char*)g.Bt + (size_t)nxt.pn * tstep : cB;
        for (int t = 0; t < nt; t += 2) {
            const bool last = (t == nt - 2);
            const char* a1 = cA + (size_t)(t + 1) * kstep;
            const char* a2 = last ? nA : cA + (size_t)(t + 2) * kstep; const char* b2 = last ? nB : cB + (size_t)(t + 2) * kstep;
            const char* a3 = a2 + kstep; const char* b3 = b2 + kstep;
            if (last && has_next) S.a_ready(nxt);
            if constexpr (SP2) {
            PG8_LDB(B0, 0, 0); PG8_LDB(B1, 0, 1); PG8_SCHED; PG8_LDA(At, 0, 0); PG8_STAGE(PG8_SA(1, 1), a1 + hstep, voffA);
            PG8_WAIT_V(8); PG8_WAIT_L(0); PG8_BAR; PG8_MMA(0, 0, At, B0); PG8_MMA(0, 1, At, B1); PG8_BAR; PG8_SCHED;
            PG8_LDA(At, 0, 1); PG8_STAGE(PG8_SB(0, 0), b2, voffB); PG8_STAGE(PG8_SB(0, 1), b2 + hstep, voffB); PG8_STAGE(PG8_SA(0, 0), a2, voffA);
            PG8_WAIT_V(8); PG8_WAIT_L(0); PG8_BAR; PG8_MMA(1, 0, At, B0); PG8_MMA(1, 1, At, B1); PG8_BAR; PG8_SCHED;
            PG8_LDB(B0, 1, 0); PG8_LDB(B1, 1, 1); PG8_SCHED; PG8_LDA(At, 1, 0); PG8_STAGE(PG8_SA(0, 1), a2 + hstep, voffA);
            PG8_WAIT_V(8); PG8_WAIT_L(0); PG8_BAR; PG8_MMA(0, 0, At, B0); PG8_MMA(0, 1, At, B1); PG8_BAR; PG8_SCHED;
            PG8_LDA(At, 1, 1); PG8_STAGE(PG8_SB(1, 0), b3, voffB); PG8_STAGE(PG8_SB(1, 1), b3 + hstep, voffB); PG8_STAGE(PG8_SA(1, 0), a3, voffA);
            PG8_WAIT_V(8); PG8_WAIT_L(0); PG8_BAR; PG8_MMA(1, 0, At, B0); PG8_MMA(1, 1, At, B1); PG8_BAR; PG8_SCHED;
            } else {
            PG8_LDB(B0, 0, 0); PG8_SCHED; PG8_LDA(At, 0, 0); PG8_STAGE(PG8_SA(1, 1), a1 + hstep, voffA);
            PG8_WAIT_L(8); PG8_BAR; PG8_WAIT_L(0); PG8_MMA(0, 0, At, B0); PG8_BAR; PG8_SCHED;
            PG8_LDB(B1, 0, 1); PG8_STAGE(PG8_SB(0, 0), b2, voffB);
            PG8_BAR; PG8_WAIT_L(0); PG8_MMA(0, 1, At, B1); PG8_BAR;
            PG8_LDA(At, 0, 1); PG8_STAGE(PG8_SA(0, 0), a2, voffA);
            PG8_BAR; PG8_WAIT_L(0); PG8_MMA(1, 0, At, B0); PG8_BAR; PG8_SCHED;
            PG8_STAGE(PG8_SB(0, 1), b2 + hstep, voffB);
            PG8_WAIT_V(6); PG8_BAR; PG8_MMA(1, 1, At, B1); PG8_BAR;
            PG8_LDB(B0, 1, 0); PG8_SCHED; PG8_LDA(At, 1, 0); PG8_STAGE(PG8_SA(0, 1), a2 + hstep, voffA);
            PG8_WAIT_L(8); PG8_BAR; PG8_WAIT_L(0); PG8_MMA(0, 0, At, B0); PG8_BAR; PG8_SCHED;
            PG8_LDB(B1, 1, 1); PG8_STAGE(PG8_SB(1, 0), b3, voffB);
            PG8_BAR; PG8_WAIT_L(0); PG8_MMA(0, 1, At, B1); PG8_BAR;
            PG8_LDA(At, 1, 1); PG8_STAGE(PG8_SA(1, 0), a3, voffA);
            PG8_BAR; PG8_WAIT_L(0); PG8_MMA(1, 0, At, B0); PG8_BAR; PG8_SCHED;
            PG8_STAGE(PG8_SB(1, 1), b3 + hstep, voffB);
            PG8_WAIT_V(6); PG8_BAR; PG8_MMA(1, 1, At, B1); PG8_BAR;
            }
        }
        if constexpr (ALIGN_EPI) { if (wr == 0) PG8_BAR; }
        if constexpr (!Epi::AFTER_DRAIN) { E(acc, cur, wr, wc, fr, fq); S.done(cur); }
        if (!has_next) break;
#pragma unroll
        for (int a = 0; a < 2; ++a)
#pragma unroll
            for (int b = 0; b < 2; ++b)
#pragma unroll
                for (int m = 0; m < 4; ++m)
#pragma unroll
                    for (int n = 0; n < 2; ++n) acc[a][b][m][n] = (f32x4){0.f, 0.f, 0.f, 0.f};
        cur = nxt; cA = nA; cB = nB; ++ui;
        if constexpr (ALIGN_EPI) { if (wr == 1) PG8_BAR; }
    }
    PG8_WAIT_V(0);
    if constexpr (!ALIGN_EPI) { if (wr == 0) PG8_BAR; }
    PG8_BAR;
    if constexpr (Epi::AFTER_DRAIN) { E.fused(acc, cur, wr, wc, fr, fq, lds, wid, lane); S.done(cur); }
#undef PG8_SA
#undef PG8_SB
#undef PG8_STAGE
#undef PG8_LDA
#undef PG8_LDB
#undef PG8_MMA
#undef PG8_WAIT_V
#undef PG8_WAIT_L
#undef PG8_BAR
#undef PG8_SCHED
}
}

#ifndef PG8_SP2
#define PG8_SP2 true
#endif
#ifndef PG8_ALIGN
#define PG8_ALIGN true
#endif
#define GAS __attribute__((address_space(1)))
#define LAS __attribute__((address_space(3)))
typedef unsigned short bf16;
typedef unsigned v4u __attribute__((ext_vector_type(4)));
typedef float f32x4 __attribute__((ext_vector_type(4)));
typedef short bf16x8 __attribute__((ext_vector_type(8)));
typedef GAS unsigned gu32;
typedef GAS unsigned long long gu64;
#define RLX_AGENT __ATOMIC_RELAXED, __HIP_MEMORY_SCOPE_AGENT
#define LDS_WAIT() asm volatile("s_waitcnt lgkmcnt(0)" ::: "memory")
#define VM_WAIT() asm volatile("s_waitcnt vmcnt(0)" ::: "memory")
__device__ __forceinline__ unsigned long long rt() { return __builtin_amdgcn_s_memrealtime(); }
__device__ __forceinline__ unsigned f2bf(float f) { unsigned u = __builtin_bit_cast(unsigned, f); return (u + 0x7fffu + ((u >> 16) & 1u)) >> 16; }
__device__ __forceinline__ unsigned pk2(float lo, float hi) { return f2bf(lo) | (f2bf(hi) << 16); }

#define XB_TMO      128
#define XB_XCNT(j)  (256  + 64 * (j))
#define XB_XSUB(j)  (1280 + 64 * (j))
#define XB_XGEN(j)  (2304 + 64 * (j))
#define XB_TOP      3328
#define XB_TOPGEN   3392
#define XCD_BAR_WORDS 3456
#define XB_SPIN_CAP (1u << 18)

__device__ __forceinline__ unsigned xb_ld(unsigned* p)              { return __hip_atomic_load(p, __ATOMIC_RELAXED, __HIP_MEMORY_SCOPE_AGENT); }
__device__ __forceinline__ unsigned xb_add(unsigned* p, unsigned v) { return __hip_atomic_fetch_add(p, v, __ATOMIC_RELAXED, __HIP_MEMORY_SCOPE_AGENT); }
__device__ __forceinline__ unsigned xb_xcc_id() { return (unsigned)__builtin_amdgcn_s_getreg((3 << 11) | 20) & 0xFu; }
#define XB_SPIN(cond, bar) do { unsigned _sp = 0; while (cond) { __builtin_amdgcn_s_sleep(1); \
    if ((++_sp & 255u) == 0u) { if (xb_ld(&(bar)[XB_TMO])) break; if (_sp > XB_SPIN_CAP) { atomicAdd(&(bar)[XB_TMO], 1u); break; } } } } while (0)

struct XcdBarrier {
    unsigned* bar; unsigned x;
    volatile LAS unsigned* st;
};

__device__ __forceinline__ XcdBarrier xcd_barrier_post(unsigned* bar, volatile LAS unsigned* st) {
    XcdBarrier b; b.bar = bar; b.x = xb_xcc_id(); b.st = st;
    if (threadIdx.x == 0) (void)xb_add(&bar[XB_XCNT(b.x)], 1u);
    return b;
}
__device__ __forceinline__ void xcd_barrier_complete(unsigned* bar, unsigned x, unsigned& nloc, unsigned& nx) {
    const unsigned G = gridDim.x * gridDim.y * gridDim.z;
    unsigned sum, cnt, mine, sp = 0u;
    for (;;) {
        sum = 0u; cnt = 0u; mine = 0u;
#pragma unroll
        for (unsigned j = 0; j < 16; ++j) { const unsigned c = xb_ld(&bar[XB_XCNT(j)]); sum += c; cnt += (c > 0u) ? 1u : 0u; mine = (j == x) ? c : mine; }
        if (sum == G) break;
        __builtin_amdgcn_s_sleep(1);
        if ((++sp & 255u) == 0u) { if (xb_ld(&bar[XB_TMO])) break; if (sp > XB_SPIN_CAP) { atomicAdd(&bar[XB_TMO], 1u); break; } }
    }
    nloc = mine > 0u ? mine : 1u; nx = cnt > 0u ? cnt : 1u;
}

__device__ __forceinline__ void xcd_barrier(const XcdBarrier& b) {
    asm volatile("s_waitcnt vmcnt(0)" ::: "memory");
    __syncthreads();
    if (threadIdx.x == 0) {
        unsigned* bar = b.bar;
        __builtin_amdgcn_s_waitcnt(0);
        unsigned nloc = b.st[0], nx = b.st[1];
        if (nloc == 0u) { xcd_barrier_complete(bar, b.x, nloc, nx); b.st[0] = nloc; b.st[1] = nx; }
        const unsigned old = xb_add(&bar[XB_XSUB(b.x)], 1u);
        const unsigned gen = old / nloc;
        if (old + 1u == (gen + 1u) * nloc) {
            __builtin_amdgcn_fence(__ATOMIC_RELEASE, "agent");
            asm volatile("s_waitcnt vmcnt(0)" ::: "memory");
            const unsigned og = xb_add(&bar[XB_TOP], 1u);
            const unsigned tg = og / nx;
            if (og + 1u == (tg + 1u) * nx) xb_add(&bar[XB_TOPGEN], 1u);
            else XB_SPIN(xb_ld(&bar[XB_TOPGEN]) == tg, bar);
            __builtin_amdgcn_fence(__ATOMIC_ACQUIRE, "agent");
            xb_add(&bar[XB_XGEN(b.x)], 1u);
            asm volatile("s_waitcnt vmcnt(0)" ::: "memory");
        } else {
            XB_SPIN(xb_ld(&bar[XB_XGEN(b.x)]) == gen, bar);
            __builtin_amdgcn_fence(__ATOMIC_ACQUIRE, "agent");
            asm volatile("s_waitcnt vmcnt(0)" ::: "memory");
        }
    }
    __syncthreads();
}

constexpr int DM = 1024, NPR = 8192, NTOK = 16384, SEQP = 256, SEQS = 4096, PAST = 256, SKVS = SEQS + PAST;
constexpr int DFF = 2816, NGU = 2 * DFF, DIN = 2560, DH = 512;
constexpr int NMOD = 9 * DM;
constexpr float EPS_N = 1e-6f;
constexpr int NWAVES = 8;

constexpr size_t MiB = 1u << 20;
constexpr size_t WS_CTL = 0, CTL_ZERO_BYTES = 1 * MiB;
constexpr size_t WS_WGU1 = 2 * MiB, WS_WD1 = 13 * MiB, WS_WGU2 = 19 * MiB, WS_WD2 = 30 * MiB, WS_WIN = 36 * MiB, WS_WOUT = 41 * MiB, WS_WRG = 43 * MiB, WS_TAB = 43 * MiB + 512 * 1024;
constexpr size_t WS_H = 44 * MiB, WS_MIX = 76 * MiB, WS_HID = 108 * MiB;
constexpr size_t WS_Q = 108 * MiB, WS_XR = 124 * MiB, WS_XG = 140 * MiB;
constexpr size_t WS_COMP = 196 * MiB, WS_KB = 197 * MiB, WS_VB = 214 * MiB, WS_END = 231 * MiB;
static_assert(WS_HID + (size_t)NTOK * DFF * 2 <= WS_COMP && WS_XG + (size_t)NTOK * DH * 2 <= WS_COMP, "ws map");
constexpr int CW_TMO = 0, CW_CODE = 1, CW_BAR = 4096, CW_MOD = 32768;
static_assert((CW_MOD + 3 * NMOD) * 4 <= (int)CTL_ZERO_BYTES, "ctl");
constexpr int TAB_COS = 0, TAB_SIN = 1024, TAB_SP = 2048;

constexpr int RING_OFF = 0, RING_BYTES = 131072;
constexpr int LDSCTL_OFF = RING_BYTES, MISC_OFF = LDSCTL_OFF + 320;
constexpr int LDS_BYTES = 147456;

__device__ __forceinline__ float wave_sum(float v) {
#pragma unroll
    for (int o = 1; o < 64; o <<= 1) v += __shfl_xor(v, o);
    return v;
}
__device__ __forceinline__ float fast_sigmoid(float x) { return __builtin_amdgcn_rcpf(1.0f + __builtin_amdgcn_exp2f(-1.4426950408889634f * x)); }
__device__ __forceinline__ int cond_of_row(int m) { return m < NPR ? 0 : 1 + ((m - NPR) >> 12); }

struct EpiSwiglu {
    static constexpr bool PERM = true, AFTER_DRAIN = false;
    bf16* H;
    __device__ __forceinline__ void operator()(const pg8::f32x4 (&acc)[2][2][4][2], const pg8::Unit& u, int wr, int wc, int fr, int fq) const {
        const int row0 = u.pm * 256 + wr * 64 + fr, hc0 = u.pn * 128 + wc * 32 + 8 * fq;
#pragma unroll
        for (int ai = 0; ai < 2; ++ai)
#pragma unroll
            for (int m = 0; m < 4; ++m) {
                bf16* rowp = H + (size_t)(row0 + ai * 128 + m * 16) * DFF + hc0;
                float hv[8];
#pragma unroll
                for (int n = 0; n < 2; ++n)
#pragma unroll
                    for (int e = 0; e < 4; ++e) { const float g = acc[ai][0][m][n][e], up = acc[ai][1][m][n][e]; hv[4 * n + e] = g * fast_sigmoid(g) * up; }
                pg8::u32x4 w; w.x = pg8::cvt_pk_bf16(hv[0], hv[1]); w.y = pg8::cvt_pk_bf16(hv[2], hv[3]); w.z = pg8::cvt_pk_bf16(hv[4], hv[5]); w.w = pg8::cvt_pk_bf16(hv[6], hv[7]);
                *(pg8::u32x4*)rowp = w;
            }
    }
};
struct EpiRes {
    static constexpr bool PERM = false, AFTER_DRAIN = false;
    const float* base_p; const float* base_s; float* out; const float* modv; int gidx; float scale;
    __device__ __forceinline__ void operator()(const pg8::f32x4 (&acc)[2][2][4][2], const pg8::Unit& u, int wr, int wc, int fr, int fq) const {
        const int cond = u.pm < 32 ? 0 : 1 + ((u.pm - 32) >> 4);
        const float* base = u.pm < 32 ? base_p + (size_t)u.pm * 256 * DM : base_s + (size_t)(u.pm - 32) * 256 * DM;
        float* outp = out + (size_t)u.pm * 256 * DM;
        const int col0 = u.pn * 256 + wc * 32 + 4 * fq;
        const float* gp = modv + cond * NMOD + gidx * DM + col0;
        pg8::f32x4 gv[2][2];
#pragma unroll
        for (int bj = 0; bj < 2; ++bj)
#pragma unroll
            for (int n = 0; n < 2; ++n) gv[bj][n] = *(const pg8::f32x4*)(gp + bj * 128 + n * 16) * scale;
#pragma unroll
        for (int ai = 0; ai < 2; ++ai)
#pragma unroll
            for (int m = 0; m < 4; ++m) { const size_t off = (size_t)(ai * 128 + wr * 64 + m * 16 + fr) * DM + col0;
#pragma unroll
                for (int bj = 0; bj < 2; ++bj)
#pragma unroll
                    for (int n = 0; n < 2; ++n) { const pg8::f32x4 b = *(const pg8::f32x4*)(base + off + bj * 128 + n * 16); *(pg8::f32x4*)(outp + off + bj * 128 + n * 16) = b + gv[bj][n] * acc[ai][bj][m][n]; }
                if (m & 1) asm volatile("" ::: "memory"); }
    }
};
struct EpiProj {
    static constexpr bool PERM = false, AFTER_DRAIN = false;
    bf16 *Q, *KB, *VB, *XR, *XG; float *outK, *outV; const float *cosT, *sinT;
    __device__ __forceinline__ static void st4(bf16* p, const pg8::f32x4& v) { typedef unsigned u32x2 __attribute__((ext_vector_type(2))); u32x2 w; w.x = pg8::cvt_pk_bf16(v[0], v[1]); w.y = pg8::cvt_pk_bf16(v[2], v[3]); *(u32x2*)p = w; }
    __device__ __forceinline__ void operator()(const pg8::f32x4 (&acc)[2][2][4][2], const pg8::Unit& u, int wr, int wc, int fr, int fq) const {
        const int type = u.pn >> 1, half = u.pn & 1; const bool sample = u.pm >= 32;
        const int row0 = u.pm * 256 + wr * 64 + fr, lc0 = half * 256 + wc * 32 + 4 * fq;
        if (type <= 1) {
            bf16* dst = type == 0 ? Q : KB;
#pragma unroll
            for (int ai = 0; ai < 2; ++ai)
#pragma unroll
                for (int m = 0; m < 4; ++m) {
                    const int r = row0 + ai * 128 + m * 16;
                    const int drow = (type == 1 && sample) ? r + ((r - NPR) >> 12) * PAST : r;
                    pg8::f32x4 cs = {1.f, 1.f, 1.f, 1.f}, sn = {0.f, 0.f, 0.f, 0.f};
                    if (sample) { const int t = (r - NPR) & (SEQS - 1); const int pos = (wc & 1) ? (t & 63) : (t >> 6); cs = *(const pg8::f32x4*)(cosT + pos * 16 + 4 * fq); sn = *(const pg8::f32x4*)(sinT + pos * 16 + 4 * fq); }
#pragma unroll
                    for (int bj = 0; bj < 2; ++bj) {
                        const pg8::f32x4 x1 = acc[ai][bj][m][0], x2 = acc[ai][bj][m][1];
                        const pg8::f32x4 y1 = x1 * cs - x2 * sn, y2 = x1 * sn + x2 * cs;
                        bf16* p = dst + (size_t)drow * DH + lc0 + bj * 128;
                        st4(p, y1); st4(p + 16, y2);
                        if (type == 1 && !sample) { float* o = outK + (size_t)r * DH + lc0 + bj * 128; *(pg8::f32x4*)o = y1; *(pg8::f32x4*)(o + 16) = y2; }
                    }
                }
        } else if (type == 2) {
#pragma unroll
            for (int ai = 0; ai < 2; ++ai)
#pragma unroll
                for (int m = 0; m < 4; ++m) {
                    const int r = row0 + ai * 128 + m * 16;
                    const int drow = sample ? r + ((r - NPR) >> 12) * PAST : r;
#pragma unroll
                    for (int bj = 0; bj < 2; ++bj)
#pragma unroll
                        for (int n = 0; n < 2; ++n) {
                            st4(VB + (size_t)drow * DH + lc0 + bj * 128 + n * 16, acc[ai][bj][m][n]);
                            if (!sample) *(pg8::f32x4*)(outV + (size_t)r * DH + lc0 + bj * 128 + n * 16) = acc[ai][bj][m][n];
                        }
                }
        } else {
            bf16* dst = type == 3 ? XR : XG;
#pragma unroll
            for (int ai = 0; ai < 2; ++ai)
#pragma unroll
                for (int m = 0; m < 4; ++m) {
                    const int r = row0 + ai * 128 + m * 16;
#pragma unroll
                    for (int bj = 0; bj < 2; ++bj)
#pragma unroll
                        for (int n = 0; n < 2; ++n) st4(dst + (size_t)r * DH + lc0 + bj * 128 + n * 16, acc[ai][bj][m][n]);
                }
        }
    }
};

__device__ __forceinline__ void transpose_item(const float* W, int N, int K, int k0, int n0, bf16* WT, int drow0, LAS float* scr, int lane) {
#pragma unroll 8
    for (int i = 0; i < 32; ++i) { const int kk = 2 * i + (lane >> 5); scr[kk * 33 + (lane & 31)] = W[(size_t)(k0 + kk) * N + n0 + (lane & 31)]; }
    LDS_WAIT(); asm volatile("" ::: "memory");
    const int c = lane & 7;
#pragma unroll
    for (int j = 0; j < 4; ++j) { const int n = (lane >> 3) + 8 * j; const LAS float* s = scr + (8 * c) * 33 + n;
        v4u o; o.x = pk2(s[0 * 33], s[1 * 33]); o.y = pk2(s[2 * 33], s[3 * 33]); o.z = pk2(s[4 * 33], s[5 * 33]); o.w = pk2(s[6 * 33], s[7 * 33]);
        *(GAS v4u*)(WT + (size_t)(drow0 + n) * K + k0 + 8 * c) = o; }
    LDS_WAIT(); asm volatile("" ::: "memory");
}

struct Ptrs {
    const float *x_prompt, *x_sample, *cache_k, *cache_v, *state, *c, *c_ctx, *norm_g, *w_mod, *b_mod, *w_gate, *w_up, *w_down, *w_in, *w_out, *diff_lambda, *subln_g, *conv_w, *conv_b,
        *rg_w_r, *rg_b_r, *rg_w_i, *rg_b_i, *rg_lambda, *final_g;
    float* out; float *out_k, *out_v, *out_state;
    bf16 *Wgu1, *Wd1, *Wgu2, *Wd2, *Win, *Wout, *Wrg, *H, *MIX, *HID, *Q, *XR, *XG, *KB, *VB;
    float *tab, *comp, *modv;
};

__device__ __forceinline__ void p0_prologue(const Ptrs& P, LAS unsigned char* lds, int vcu, int G, int tid, int wave, int lane) {
    const int gw = vcu * NWAVES + wave, NGW = G * NWAVES;
    for (int u = gw; u < 36 * 32; u += NGW) {
        const int nch = u % 36, ks = u / 36, n = nch * 256 + lane * 4, kbase = ks * 32;
        float s0, s1, s2; { const int k = kbase + (lane & 31); const float a = P.c_ctx[k], b = P.c[k], c2 = P.c[DM + k]; s0 = a / (1.f + expf(-a)); s1 = b / (1.f + expf(-b)); s2 = c2 / (1.f + expf(-c2)); }
        f32x4 a0 = {0.f, 0.f, 0.f, 0.f}, a1 = a0, a2 = a0;
#pragma unroll
        for (int kk = 0; kk < 32; ++kk) { const f32x4 w = *(const f32x4*)(P.w_mod + (size_t)(kbase + kk) * NMOD + n);
            const float t0 = __shfl(s0, kk), t1 = __shfl(s1, kk), t2 = __shfl(s2, kk); a0 += w * t0; a1 += w * t1; a2 += w * t2; }
        if (ks == 0) { const f32x4 bb = *(const f32x4*)(P.b_mod + n); a0 += bb; a1 += bb; a2 += bb; }
#pragma unroll
        for (int e = 0; e < 4; ++e) { atomicAdd(P.modv + n + e, a0[e]); atomicAdd(P.modv + NMOD + n + e, a1[e]); atomicAdd(P.modv + 2 * NMOD + n + e, a2[e]); }
    }
    LAS float* scr = (LAS float*)(lds + RING_OFF + wave * 16384);
    for (int it = gw; it < 10240; it += NGW) {
        int r = it;
        if (r < 5632) { const int combo = r / 1408, rr = r % 1408, f = combo >> 1, s = combo & 1, kb = rr / 88, nb = rr % 88, n0 = 32 * nb;
            transpose_item((s ? P.w_up : P.w_gate) + (size_t)f * DM * DFF, DFF, DM, 64 * kb, n0, f ? P.Wgu2 : P.Wgu1, 256 * (n0 >> 7) + 128 * s + (n0 & 127), scr, lane); continue; }
        r -= 5632;
        if (r < 2816) { const int f = r / 1408, rr = r % 1408, kb = rr / 32, nb = rr % 32;
            transpose_item(P.w_down + (size_t)f * DFF * DM, DM, DFF, 64 * kb, 32 * nb, f ? P.Wd2 : P.Wd1, 32 * nb, scr, lane); continue; }
        r -= 2816;
        if (r < 1280) { const int kb = r / 80, nb = r % 80; transpose_item(P.w_in, DIN, DM, 64 * kb, 32 * nb, P.Win, 32 * nb, scr, lane); continue; }
        r -= 1280;
        { const int kb = r / 32, nb = r % 32; transpose_item(P.w_out, DM, DM, 64 * kb, 32 * nb, P.Wout, 32 * nb, scr, lane); }
    }
    const int gt = vcu * (NWAVES * 64) + tid, NGT = G * NWAVES * 64;
    for (int e = gt; e < 131072; e += NGT) {
        const int c = e & 63, d = (e >> 6) & 63, blk = (e >> 12) & 7, gate = (e >> 15) & 1, dir = (e >> 16) & 1;
        const float v = (gate ? P.rg_w_i : P.rg_w_r)[((dir * 8 + blk) * 64 + c) * 64 + d];
        P.Wrg[e] = (bf16)f2bf(v);
    }
    for (int e = gt; e < 1024; e += NGT) {
        const int pos = e >> 4, i = e & 15; const float inv = powf(10000.0f, -(float)i / 16.0f); const float ang = (float)pos * inv;
        P.tab[TAB_COS + e] = cosf(ang); P.tab[TAB_SIN + e] = sinf(ang);
        P.tab[TAB_SP + e] = log1pf(expf(-P.rg_lambda[e]));
    }
    for (int e = gt; e < 2 * 32768; e += NGT) {
        const int which = e >> 15, e8 = e & 32767, idx = e8 * 8, b = idx / (PAST * DH), rem = idx % (PAST * DH), j = rem / DH, col = rem % DH;
        const float* src = (which ? P.cache_v : P.cache_k) + idx; const f32x4 v0 = *(const f32x4*)src, v1 = *(const f32x4*)(src + 4);
        v4u o; o.x = pk2(v0[0], v0[1]); o.y = pk2(v0[2], v0[3]); o.z = pk2(v1[0], v1[1]); o.w = pk2(v1[2], v1[3]);
        *(v4u*)((which ? P.VB : P.KB) + (size_t)(NPR + b * SKVS + SEQS + j) * DH + col) = o;
    }
}

template <bool FINAL>
__device__ __forceinline__ void norm_phase(const float* src_p, const float* src_s, const float* gvec, const float* modv, int sh_idx, int sc_idx, bf16* dsth, float* dstf, int gw, int NGW, int lane) {
    for (int grp = gw; grp < NTOK / 8; grp += NGW) {
        const int m0 = grp * 8, cond = cond_of_row(m0);
        const float* src = m0 < NPR ? src_p + (size_t)m0 * DM : src_s + (size_t)(m0 - NPR) * DM;
        f32x4 A[4], B[4];
#pragma unroll
        for (int j = 0; j < 4; ++j) { const int c = 4 * lane + 256 * j; const f32x4 g = *(const f32x4*)(gvec + c);
            if (!FINAL) { const f32x4 sc = *(const f32x4*)(modv + cond * NMOD + sc_idx * DM + c); A[j] = g * (sc + 1.0f); B[j] = *(const f32x4*)(modv + cond * NMOD + sh_idx * DM + c); }
            else { A[j] = g; B[j] = (f32x4){0.f, 0.f, 0.f, 0.f}; } }
        for (int r = 0; r < 8; ++r) {
            const float* xr = src + (size_t)r * DM + 4 * lane;
            f32x4 v[4]; float ss = 0.f;
#pragma unroll
            for (int j = 0; j < 4; ++j) { v[j] = *(const f32x4*)(xr + 256 * j); ss += (v[j][0] * v[j][0] + v[j][1] * v[j][1]) + (v[j][2] * v[j][2] + v[j][3] * v[j][3]); }
            const float rstd = 1.0f / sqrtf(wave_sum(ss) * (1.0f / DM) + EPS_N);
#pragma unroll
            for (int j = 0; j < 4; ++j) { const f32x4 o = v[j] * rstd * A[j] + B[j];
                if (FINAL) *(f32x4*)(dstf + (size_t)(m0 + r) * DM + 4 * lane + 256 * j) = o;
                else { typedef unsigned u32x2 __attribute__((ext_vector_type(2))); u32x2 w; w.x = pk2(o[0], o[1]); w.y = pk2(o[2], o[3]); *(u32x2*)(dsth + (size_t)(m0 + r) * DM + 4 * lane + 256 * j) = w; } }
        }
    }
}

namespace att {
using bf16x8 = __attribute__((ext_vector_type(8))) short;
using s16x4  = __attribute__((ext_vector_type(4))) short;
using f32x16 = __attribute__((ext_vector_type(16))) float;
using f32x4  = __attribute__((ext_vector_type(4))) float;
using u32x4  = __attribute__((ext_vector_type(4))) unsigned;
constexpr int NW = 8, QBLK = 32, KVBLK = 64, LDX = 512;
constexpr float SCALE = 0.125f, THR = 8.f;
constexpr size_t SHM_V = KVBLK * 128 * 2, SHM_K = KVBLK * 128 * 2;
constexpr int EP_STRIDE = 132, WS_OFF = 69632;
static_assert(4 * 32 * EP_STRIDE * 4 <= WS_OFF && 2 * SHM_V + 2 * SHM_K <= WS_OFF, "attention LDS map");
constexpr int LDS_BYTES_ATT = WS_OFF + NW * 64 * 4;
#define KSWZ(row, colB) ((row) * 256 + ((colB) ^ (((row) & 7) << 4)))
#define SBAR() __builtin_amdgcn_sched_barrier(0)
__device__ __forceinline__ int crow(int r, int hi) { return (r & 3) + 8 * (r >> 2) + 4 * hi; }
__device__ __forceinline__ unsigned cvtpk(float lo, float hi) { unsigned r; asm volatile("v_cvt_pk_bf16_f32 %0, %1, %2" : "=v"(r) : "v"(lo), "v"(hi)); return r; }

__device__ __forceinline__ void partialSM(f32x16& p0, f32x16& p1, float& m_reg, float& mn, float& alpha) {
  constexpr float C = SCALE * 1.4426950408889634f;
  float pmax = p0[0]; for (int r = 1; r < 16; ++r) pmax = fmaxf(pmax, p0[r]); for (int r = 0; r < 16; ++r) pmax = fmaxf(pmax, p1[r]);
  { auto rr = __builtin_amdgcn_permlane32_swap(__float_as_uint(pmax), __float_as_uint(pmax), false, false);
    pmax = fmaxf(__uint_as_float(rr[0]), __uint_as_float(rr[1])); }
  if (__builtin_expect(__all(pmax - m_reg <= THR / SCALE), 1)) { mn = m_reg; alpha = 1.f; }
  else { mn = fmaxf(m_reg, pmax); alpha = __builtin_amdgcn_exp2f((m_reg - mn) * C); m_reg = mn; }
  float mnC = -mn * C;
  for (int r = 0; r < 16; ++r) p0[r] = fmaf(p0[r], C, mnC); for (int r = 0; r < 16; ++r) p1[r] = fmaf(p1[r], C, mnC);
  for (int r = 0; r < 16; ++r) p0[r] = __builtin_amdgcn_exp2f(p0[r]);
}
__device__ __forceinline__ void finishSM(f32x16& p0, f32x16& p1, float alpha, float& l_reg, bf16x8& pa0, bf16x8& pa1, bf16x8& pa2, bf16x8& pa3) {
  for (int r = 0; r < 16; ++r) p1[r] = __builtin_amdgcn_exp2f(p1[r]);
  float ps = 0; for (int r = 0; r < 16; ++r) ps += p0[r]; for (int r = 0; r < 16; ++r) ps += p1[r];
  { auto rr = __builtin_amdgcn_permlane32_swap(__float_as_uint(ps), __float_as_uint(ps), false, false);
    ps = __uint_as_float(rr[0]) + __uint_as_float(rr[1]); }
  l_reg = l_reg * alpha + ps;
#define PK4(P, BASE, OUT) do { unsigned a0 = cvtpk(P[BASE + 0], P[BASE + 1]), a1 = cvtpk(P[BASE + 2], P[BASE + 3]);   \
    unsigned b0 = cvtpk(P[BASE + 4], P[BASE + 5]), b1 = cvtpk(P[BASE + 6], P[BASE + 7]);                              \
    auto r0 = __builtin_amdgcn_permlane32_swap(a0, b0, false, false); auto r1 = __builtin_amdgcn_permlane32_swap(a1, b1, false, false); \
    u32x4 w = {r0[0], r1[0], r0[1], r1[1]}; OUT = *reinterpret_cast<bf16x8*>(&w); } while (0)
  PK4(p0, 0, pa0); PK4(p0, 8, pa1); PK4(p1, 0, pa2); PK4(p1, 8, pa3);
#undef PK4
}
__device__ __forceinline__ void qkt(f32x16& p0, f32x16& p1, const char* Ks, const bf16x8* qr, int r32, int hi, int map) {
  p0 = f32x16{}; p1 = f32x16{};
#pragma unroll
  for (int d0 = 0; d0 < 4; ++d0) { int cb = (map * 64 + d0 * 16 + hi * 8) * 2;
    bf16x8 b0 = *reinterpret_cast<const bf16x8*>(Ks + KSWZ(r32, cb));
    bf16x8 b1 = *reinterpret_cast<const bf16x8*>(Ks + KSWZ(32 + r32, cb));
    p0 = __builtin_amdgcn_mfma_f32_32x32x16_bf16(b0, qr[d0], p0, 0, 0, 0);
    p1 = __builtin_amdgcn_mfma_f32_32x32x16_bf16(b1, qr[d0], p1, 0, 0, 0); }
}
__device__ __forceinline__ int v_st(int k, int c) { const int kk = (k & ~0xC) | ((k & 4) << 1) | ((k & 8) >> 1); return ((kk >> 3) * 4 + (c >> 5)) * 512 + ((kk & 7) * 32 + (c & 31)) * 2; }
__device__ __forceinline__ int v_rd_base(int lane) { return ((lane & 3) << 3) | (((lane >> 2) & 3) << 6) | (((lane >> 4) & 1) << 5) | (((lane >> 5) & 1) << 8); }
constexpr int v_rd_off(int d0, int ks, int half) { return d0 * 512 + ks * 4096 + half * 2048; }
template <int OFF> __device__ __forceinline__ s16x4 tr_read(int vb) {
  s16x4 r; asm volatile("ds_read_b64_tr_b16 %0, %1 offset:%2" : "=&v"(r) : "v"(vb), "i"(OFF) : "memory"); return r;
}
template <int D0> __device__ __forceinline__ void pv_one(f32x16& od, int vb, bf16x8 pa0, bf16x8 pa1, bf16x8 pa2, bf16x8 pa3) {
  const s16x4 l0 = tr_read<v_rd_off(D0, 0, 0)>(vb), h0 = tr_read<v_rd_off(D0, 0, 1)>(vb), l1 = tr_read<v_rd_off(D0, 1, 0)>(vb), h1 = tr_read<v_rd_off(D0, 1, 1)>(vb);
  const s16x4 l2 = tr_read<v_rd_off(D0, 2, 0)>(vb), h2 = tr_read<v_rd_off(D0, 2, 1)>(vb), l3 = tr_read<v_rd_off(D0, 3, 0)>(vb), h3 = tr_read<v_rd_off(D0, 3, 1)>(vb);
  asm volatile("s_waitcnt lgkmcnt(0)" ::: "memory"); SBAR();
#define PK(L, H) (bf16x8){L[0], L[1], L[2], L[3], H[0], H[1], H[2], H[3]}
  od = __builtin_amdgcn_mfma_f32_32x32x16_bf16(pa0, PK(l0, h0), od, 0, 0, 0);
  od = __builtin_amdgcn_mfma_f32_32x32x16_bf16(pa1, PK(l1, h1), od, 0, 0, 0);
  od = __builtin_amdgcn_mfma_f32_32x32x16_bf16(pa2, PK(l2, h2), od, 0, 0, 0);
  od = __builtin_amdgcn_mfma_f32_32x32x16_bf16(pa3, PK(l3, h3), od, 0, 0, 0);
#undef PK
}
__device__ __forceinline__ void pv_d0(f32x16* o, int vb, bf16x8 pa0, bf16x8 pa1, bf16x8 pa2, bf16x8 pa3) {
  pv_one<0>(o[0], vb, pa0, pa1, pa2, pa3); pv_one<1>(o[1], vb, pa0, pa1, pa2, pa3); pv_one<2>(o[2], vb, pa0, pa1, pa2, pa3); pv_one<3>(o[3], vb, pa0, pa1, pa2, pa3);
}

__device__ __forceinline__ void attn_unit(const unsigned short* __restrict__ Qb, const unsigned short* __restrict__ Kh, const unsigned short* __restrict__ Vh,
                                          unsigned short* __restrict__ Ob, int seq, float lam, const float* __restrict__ subg, char* lds) {
  const int tid = threadIdx.x, wid = tid >> 6, lane = tid & 63, r32 = lane & 31, hi = lane >> 5;
  const int map = wid & 1, qs = wid >> 1;
  char* V_lds = lds; char* K_lds = lds + 2 * SHM_V;
  float* ws = (float*)(lds + WS_OFF) + wid * 64; float* li_l = ws; float* al_l = ws + 32;
  float m_reg = -1e30f, l_reg = 0; f32x16 o[4] = {}; bf16x8 qr[4];
  const unsigned short* Qw = Qb + (long)(qs * QBLK + r32) * LDX + map * 64 + hi * 8;
#pragma unroll
  for (int d0 = 0; d0 < 4; ++d0) qr[d0] = *reinterpret_cast<const bf16x8*>(Qw + d0 * 16);
  const int sr = tid >> 4, sc = (tid & 15) * 8, vst0 = v_st(sr, sc), vst1 = v_st(32 + sr, sc);
  const int vb0 = (int)(uintptr_t)V_lds + v_rd_base(lane);
  struct { bf16x8 vs0, vs1, ks0, ks1; } sr_[2];
#define SLOAD(i, k0) do { sr_[i].vs0 = *reinterpret_cast<const bf16x8*>(&Vh[(long)((k0) + sr) * LDX + sc]); sr_[i].vs1 = *reinterpret_cast<const bf16x8*>(&Vh[(long)((k0) + 32 + sr) * LDX + sc]); \
    sr_[i].ks0 = *reinterpret_cast<const bf16x8*>(&Kh[(long)((k0) + sr) * LDX + sc]); sr_[i].ks1 = *reinterpret_cast<const bf16x8*>(&Kh[(long)((k0) + 32 + sr) * LDX + sc]); } while (0)
#define SWRITE(b, i) do { *(bf16x8*)(V_lds + (b) * SHM_V + vst0) = sr_[i].vs0;          \
    *(bf16x8*)(V_lds + (b) * SHM_V + vst1) = sr_[i].vs1; int kc = sc * 2;               \
    *(bf16x8*)(K_lds + (b) * SHM_K + KSWZ(sr, kc)) = sr_[i].ks0;                       \
    *(bf16x8*)(K_lds + (b) * SHM_K + KSWZ(32 + sr, kc)) = sr_[i].ks1; } while (0)
#define SWAIT() asm volatile("s_waitcnt vmcnt(4)" ::: "memory")
#define RESC(a) do { if (__any((a) < 1.f)) { if (hi == 0) al_l[r32] = (a); asm volatile("s_waitcnt lgkmcnt(0)" ::: "memory"); \
    for (int d = 0; d < 4; ++d) for (int r = 0; r < 16; ++r) o[d][r] *= al_l[crow(r, hi)]; } } while (0)
  f32x16 pA0, pA1, pB0, pB1; float mnA, mnB, alA, alB; bf16x8 pa0, pa1, pa2, pa3; const int NT = seq / KVBLK;
  constexpr int SE = 0, SO = 1;
  SLOAD(SE, 0); asm volatile("s_waitcnt vmcnt(0)" ::: "memory"); SWRITE(0, SE); __syncthreads();
  qkt(pA0, pA1, K_lds, qr, r32, hi, map); partialSM(pA0, pA1, m_reg, mnA, alA);
  SLOAD(SO, KVBLK); if (2 < NT) SLOAD(SE, 2 * KVBLK);
  SWAIT(); SWRITE(1, SO); __syncthreads();
  for (int j = 1; j + 1 < NT; j += 2) {
    SBAR(); qkt(pB0, pB1, K_lds + SHM_K, qr, r32, hi, map);
    finishSM(pA0, pA1, alA, l_reg, pa0, pa1, pa2, pa3); SBAR();
    SLOAD(SO, (j + 2) * KVBLK); SBAR();
    pv_d0(o, vb0, pa0, pa1, pa2, pa3); partialSM(pB0, pB1, m_reg, mnB, alB);
    __syncthreads(); SWAIT(); SWRITE(0, SE);
    RESC(alB); __syncthreads();
    SBAR(); qkt(pA0, pA1, K_lds, qr, r32, hi, map);
    finishSM(pB0, pB1, alB, l_reg, pa0, pa1, pa2, pa3); SBAR();
    if (j + 3 < NT) SLOAD(SE, (j + 3) * KVBLK); SBAR();
    pv_d0(o, vb0 + (int)SHM_V, pa0, pa1, pa2, pa3); partialSM(pA0, pA1, m_reg, mnA, alA);
    __syncthreads(); SWAIT(); SWRITE(1, SO);
    RESC(alA); __syncthreads();
  }
  SBAR(); qkt(pB0, pB1, K_lds + SHM_K, qr, r32, hi, map);
  finishSM(pA0, pA1, alA, l_reg, pa0, pa1, pa2, pa3); SBAR();
  pv_d0(o, vb0, pa0, pa1, pa2, pa3); partialSM(pB0, pB1, m_reg, mnB, alB);
  __syncthreads(); RESC(alB);
  finishSM(pB0, pB1, alB, l_reg, pa0, pa1, pa2, pa3); SBAR();
  pv_d0(o, vb0 + (int)SHM_V, pa0, pa1, pa2, pa3);
  if (hi == 0) li_l[r32] = l_reg; asm volatile("s_waitcnt lgkmcnt(0)" ::: "memory");
  { const float msc = map ? -lam : 1.f;
#pragma unroll
    for (int r = 0; r < 16; ++r) { const float f = __builtin_amdgcn_rcpf(li_l[crow(r, hi)]) * msc;
#pragma unroll
      for (int d0 = 0; d0 < 4; ++d0) o[d0][r] *= f; } }
  __syncthreads();
  float* ep = (float*)lds + qs * 32 * EP_STRIDE;
  if (map == 1) {
#pragma unroll
    for (int r = 0; r < 16; ++r)
#pragma unroll
      for (int d0 = 0; d0 < 4; ++d0) ep[crow(r, hi) * EP_STRIDE + d0 * 32 + r32] = o[d0][r];
  }
  __syncthreads();
  if (map == 0) {
#pragma unroll
    for (int r = 0; r < 16; ++r)
#pragma unroll
      for (int d0 = 0; d0 < 4; ++d0) { const int a = crow(r, hi) * EP_STRIDE + d0 * 32 + r32; ep[a] = o[d0][r] + ep[a]; }
    asm volatile("s_waitcnt lgkmcnt(0)" ::: "memory");
    const int row = lane >> 1, half = lane & 1; const float* rp = ep + row * EP_STRIDE + half * 64;
    f32x4 v[16]; float ss = 0.f;
#pragma unroll
    for (int j = 0; j < 16; ++j) { v[j] = *(const f32x4*)(rp + 4 * j); ss += (v[j][0] * v[j][0] + v[j][1] * v[j][1]) + (v[j][2] * v[j][2] + v[j][3] * v[j][3]); }
    ss += __shfl_xor(ss, 1);
    const float rstd = 0.8f / sqrtf(ss * (1.0f / 128.0f) + 1e-6f);
    unsigned short* op = Ob + (long)(qs * QBLK + row) * 1024 + half * 64;
#pragma unroll
    for (int j = 0; j < 8; ++j) { const f32x4 g0 = *(const f32x4*)(subg + half * 64 + 8 * j), g1 = *(const f32x4*)(subg + half * 64 + 8 * j + 4);
      const f32x4 a = v[2 * j] * rstd * g0, b = v[2 * j + 1] * rstd * g1;
      u32x4 w = {cvtpk(a[0], a[1]), cvtpk(a[2], a[3]), cvtpk(b[0], b[1]), cvtpk(b[2], b[3])}; *(u32x4*)(op + 8 * j) = w; }
  }
  __syncthreads();
#undef SLOAD
#undef SWRITE
#undef SWAIT
#undef RESC
}
#undef KSWZ
#undef SBAR
}

namespace rgl {
using bf16x8 = __attribute__((ext_vector_type(8))) short;
using f32x4  = __attribute__((ext_vector_type(4))) float;
constexpr int CT = 128, XS = 68;
constexpr int XC_OFF = 0, AB_OFF = 36864, COMP_OFF = 36864 + 65536, LDS_BYTES_RG = COMP_OFF + 8192;
static_assert(CT * XS * 4 <= AB_OFF, "rg lds");
__device__ __forceinline__ unsigned cvtpk(float lo, float hi) { unsigned r; asm volatile("v_cvt_pk_bf16_f32 %0, %1, %2" : "=v"(r) : "v"(lo), "v"(hi)); return r; }
__device__ __forceinline__ float bf2f(unsigned short b) { return __uint_as_float((unsigned)b << 16); }

template <bool FINAL>
__device__ __forceinline__ void rg_unit(int ck, int n, const unsigned short* __restrict__ XR, const unsigned short* __restrict__ XG, const unsigned short* __restrict__ Wrg,
                                        const float* __restrict__ conv_w, const float* __restrict__ conv_b, const float* __restrict__ b_r, const float* __restrict__ b_i,
                                        const float* __restrict__ sp, const float* __restrict__ state, float* __restrict__ comp, unsigned short* __restrict__ MIX, float* __restrict__ out_state, char* lds) {
  const int tid = threadIdx.x, wid = tid >> 6, lane = tid & 63;
  const bool sample = ck >= 64;
  const int b = sample ? (ck - 64) >> 5 : ck >> 1, cj = sample ? (ck - 64) & 31 : ck & 1, nch = sample ? 32 : 2, T = sample ? SEQS : SEQP;
  const int ck0 = ck - cj;
  const int row0 = ck * CT;
  float* XC = (float*)(lds + XC_OFF); float* Aw = (float*)(lds + AB_OFF) + wid * 2048; float* Bw = Aw + 1024; float* CP = (float*)(lds + COMP_OFF);
  float hin_f = 0.f, hin_b = 0.f;
  if (FINAL) {
    float* T2 = (float*)(lds + AB_OFF);
    for (int e = tid; e < 2 * 32 * 64; e += 512) { const int ch = e & 63, cc = (e >> 6) & 31, dir = e >> 11;
      if (cc < nch) { const float2 v = *(const float2*)(comp + ((size_t)(dir * 128 + ck0 + cc) * 512 + n * 64 + ch) * 2); *(float2*)(T2 + e * 2) = v; } }
    __syncthreads();
    hin_f = sample ? state[(b * 2 + 0) * 512 + n * 64 + lane] : 0.f; hin_b = sample ? state[(b * 2 + 1) * 512 + n * 64 + lane] : 0.f;
    for (int cc = 0; cc < cj; ++cc) { const float2 v = *(const float2*)(T2 + ((0 * 32 + cc) * 64 + lane) * 2); hin_f = v.x * hin_f + v.y; }
    for (int cc = nch - 1; cc > cj; --cc) { const float2 v = *(const float2*)(T2 + ((1 * 32 + cc) * 64 + lane) * 2); hin_b = v.x * hin_b + v.y; }
    __syncthreads();
  }
  { const int c = tid & 63, ts = tid >> 6, cg = n * 64 + c;
    const float w0 = conv_w[cg], w1 = conv_w[512 + cg], w2 = conv_w[1024 + cg], w3 = conv_w[1536 + cg], cb = conv_b[cg];
    const int t0 = cj * CT + ts * 16;
    const unsigned short* xp = XR + (size_t)(row0 + ts * 16) * DH + cg;
    float xv[19];
#pragma unroll
    for (int i = 0; i < 19; ++i) { const int t = t0 + i - 2; xv[i] = (t >= 0 && t < T) ? bf2f(xp[(long)(i - 2) * DH]) : 0.f; }
#pragma unroll
    for (int i = 0; i < 16; ++i) XC[(ts * 16 + i) * XS + c] = ((w0 * xv[i] + w1 * xv[i + 1]) + w2 * xv[i + 2]) + w3 * xv[i + 3] + cb;
  }
  __syncthreads();
  const int fr = lane & 15, kg = lane >> 4;
  bf16x8 afr[2];
#pragma unroll
  for (int ks = 0; ks < 2; ++ks) { const float* ap = XC + (wid * 16 + fr) * XS + ks * 32 + kg * 8; const f32x4 x0 = *(const f32x4*)ap, x1 = *(const f32x4*)(ap + 4);
    unsigned w[4] = {cvtpk(x0[0], x0[1]), cvtpk(x0[2], x0[3]), cvtpk(x1[0], x1[1]), cvtpk(x1[2], x1[3])}; afr[ks] = *reinterpret_cast<bf16x8*>(w); }
  float hl[2][16], pp[2][16];
#pragma unroll
  for (int dir = 0; dir < 2; ++dir) {
    f32x4 acc[2][4];
#pragma unroll
    for (int g = 0; g < 2; ++g)
#pragma unroll
      for (int db = 0; db < 4; ++db) { acc[g][db] = (f32x4){0.f, 0.f, 0.f, 0.f};
#pragma unroll
        for (int ks = 0; ks < 2; ++ks) { const bf16x8 wf = *reinterpret_cast<const bf16x8*>(Wrg + ((size_t)(((dir * 2 + g) * 8 + n) * 64 + db * 16 + fr)) * 64 + ks * 32 + kg * 8);
          acc[g][db] = __builtin_amdgcn_mfma_f32_16x16x32_bf16(afr[ks], wf, acc[g][db], 0, 0, 0); } }
#pragma unroll
    for (int db = 0; db < 4; ++db) { const int d = db * 16 + fr, dg = dir * 512 + n * 64 + d;
      const float br = b_r[dg], bi = b_i[dg], m8 = -8.0f * 1.4426950408889634f * sp[dg];
#pragma unroll
      for (int e = 0; e < 4; ++e) { const int tk = 4 * kg + e;
        const float r = fast_sigmoid(acc[0][db][e] + br), ig = fast_sigmoid(acc[1][db][e] + bi);
        const float a = __builtin_amdgcn_exp2f(r * m8);
        const float mult = sqrtf(fmaxf(fmaf(-a, a, 1.0f), 0.f));
        const float bx = mult * ig * XC[(wid * 16 + tk) * XS + d];
        Aw[tk * 64 + d] = a; Bw[tk * 64 + d] = bx; } }
    asm volatile("s_waitcnt lgkmcnt(0)" ::: "memory");
    float A = 1.f, Bv = 0.f;
#pragma unroll
    for (int jj = 0; jj < 16; ++jj) { const int j = dir ? 15 - jj : jj; const float a = Aw[j * 64 + lane], bx = Bw[j * 64 + lane];
      Bv = a * Bv + bx; A *= a; if (FINAL) { hl[dir][j] = Bv; pp[dir][j] = A; } }
    *(float2*)(CP + ((dir * 8 + wid) * 64 + lane) * 2) = make_float2(A, Bv);
    asm volatile("s_waitcnt lgkmcnt(0)" ::: "memory");
  }
  __syncthreads();
  if (!FINAL) {
    if (tid < 128) { const int dir = tid >> 6, ch = tid & 63; float A = 1.f, Bv = 0.f;
#pragma unroll
      for (int ww = 0; ww < 8; ++ww) { const int w = dir ? 7 - ww : ww; const float2 v = *(const float2*)(CP + ((dir * 8 + w) * 64 + ch) * 2); Bv = v.x * Bv + v.y; A *= v.x; }
      *(float2*)(comp + ((size_t)(dir * 128 + ck) * 512 + n * 64 + ch) * 2) = make_float2(A, Bv); }
  } else {
    float hf_in = hin_f, hb_in = hin_b;
    for (int w = 0; w < wid; ++w) { const float2 v = *(const float2*)(CP + ((0 * 8 + w) * 64 + lane) * 2); hf_in = v.x * hf_in + v.y; }
    for (int w = 7; w > wid; --w) { const float2 v = *(const float2*)(CP + ((1 * 8 + w) * 64 + lane) * 2); hb_in = v.x * hb_in + v.y; }
    const int cg = n * 64 + lane;
    const unsigned short* xgp = XG + (size_t)(row0 + wid * 16) * DH + cg; unsigned short* mp = MIX + (size_t)(row0 + wid * 16) * 1024 + 512 + cg;
#pragma unroll
    for (int j = 0; j < 16; ++j) { const float hf = hl[0][j] + pp[0][j] * hf_in, hb = hl[1][j] + pp[1][j] * hb_in;
      const float x = bf2f(xgp[(long)j * DH]); const float u2 = 1.5957691216057308f * (x + 0.044715f * x * x * x);
      const float y = (hf + hb) * x * fast_sigmoid(u2);
      mp[(long)j * 1024] = (unsigned short)(cvtpk(y, 0.f) & 0xffffu);
      if (!sample) { if (cj == 1 && wid == 7 && j == 15) out_state[b * 1024 + cg] = hf; if (cj == 0 && wid == 0 && j == 0) out_state[b * 1024 + 512 + cg] = hb; } }
  }
  __syncthreads();
}
}

#ifndef MK_PER_PHASE
#define MK_PER_PHASE 1
#endif
constexpr int N_PHASES = 13;
struct Args { const float* in[25]; float* out; unsigned char* ws; int ph_lo, ph_hi; };
static_assert(sizeof(Args) == 25 * 8 + 8 + 8 + 8, "Args has no padding");

__global__ void __launch_bounds__(NWAVES * 64, 2) fwd_kernel(Args args) {
    extern __shared__ __attribute__((aligned(16))) unsigned char lds[];
    LAS unsigned char* ldsl = (LAS unsigned char*)lds;
    volatile LAS unsigned* MISC = (volatile LAS unsigned*)(ldsl + MISC_OFF);
    const int tid = threadIdx.x, lane = tid & 63, wave = __builtin_amdgcn_readfirstlane(tid >> 6);
    const int G = gridDim.x; const int bx = blockIdx.x; const int vcu = (G % 8 == 0) ? (bx % 8) * (G / 8) + bx / 8 : bx;
    const int gw = vcu * NWAVES + wave, NGW = G * NWAVES;
    unsigned char* ws = args.ws;
    Ptrs P;
    P.x_prompt = args.in[0]; P.x_sample = args.in[1]; P.cache_k = args.in[2]; P.cache_v = args.in[3]; P.state = args.in[4]; P.c = args.in[5]; P.c_ctx = args.in[6]; P.norm_g = args.in[7];
    P.w_mod = args.in[8]; P.b_mod = args.in[9]; P.w_gate = args.in[10]; P.w_up = args.in[11]; P.w_down = args.in[12]; P.w_in = args.in[13]; P.w_out = args.in[14]; P.diff_lambda = args.in[15];
    P.subln_g = args.in[16]; P.conv_w = args.in[17]; P.conv_b = args.in[18]; P.rg_w_r = args.in[19]; P.rg_b_r = args.in[20]; P.rg_w_i = args.in[21]; P.rg_b_i = args.in[22]; P.rg_lambda = args.in[23]; P.final_g = args.in[24];
    P.out = args.out; P.out_k = args.out + (size_t)2 * NPR * DM; P.out_v = P.out_k + (size_t)NPR * DH; P.out_state = P.out_v + (size_t)NPR * DH;
    P.Wgu1 = (bf16*)(ws + WS_WGU1); P.Wd1 = (bf16*)(ws + WS_WD1); P.Wgu2 = (bf16*)(ws + WS_WGU2); P.Wd2 = (bf16*)(ws + WS_WD2); P.Win = (bf16*)(ws + WS_WIN); P.Wout = (bf16*)(ws + WS_WOUT); P.Wrg = (bf16*)(ws + WS_WRG);
    P.H = (bf16*)(ws + WS_H); P.MIX = (bf16*)(ws + WS_MIX); P.HID = (bf16*)(ws + WS_HID); P.Q = (bf16*)(ws + WS_Q); P.XR = (bf16*)(ws + WS_XR); P.XG = (bf16*)(ws + WS_XG); P.KB = (bf16*)(ws + WS_KB); P.VB = (bf16*)(ws + WS_VB);
    P.tab = (float*)(ws + WS_TAB); P.comp = (float*)(ws + WS_COMP); P.modv = (float*)(ws + WS_CTL) + CW_MOD;
    gu32* ctl = (gu32*)(ws + WS_CTL);

    for (int u = tid; u < (LDS_BYTES - LDSCTL_OFF) / 4; u += NWAVES * 64) ((LAS unsigned*)(ldsl + LDSCTL_OFF))[u] = 0u;
    __syncthreads();
    XcdBarrier bar; bar.bar = (unsigned*)(ctl + CW_BAR); bar.x = 0; bar.st = nullptr;
    if (!MK_PER_PHASE) bar = xcd_barrier_post((unsigned*)(ctl + CW_BAR), MISC + 8);
    const int lo = args.ph_lo, hi = args.ph_hi;
#define IN(k) (lo <= (k) && (k) < hi)
#define SEAM(k) do { if (IN(k) && IN((k) + 1)) xcd_barrier(bar); } while (0)

    if (IN(0)) { p0_prologue(P, ldsl, vcu, G, tid, wave, lane); } SEAM(0);
    if (IN(1)) { norm_phase<false>(P.x_prompt, P.x_sample, P.norm_g, P.modv, 0, 1, P.H, nullptr, gw, NGW, lane); } SEAM(1);
    if (IN(2)) { pg8::Gemm g{P.H, P.Wgu1, NTOK, NGU, DM}; pg8::StaticOrder S; S.init(NTOK, NGU, G, bx); EpiSwiglu E{P.HID};
        pg8::gemm_phase<EpiSwiglu, pg8::StaticOrder, PG8_ALIGN, PG8_SP2>(ldsl + RING_OFF, g, S, E); } SEAM(2);
    if (IN(3)) { pg8::Gemm g{P.HID, P.Wd1, NTOK, DM, DFF}; pg8::StaticOrder S; S.init(NTOK, DM, G, bx); EpiRes E{P.x_prompt, P.x_sample, P.out, P.modv, 2, 0.5f};
        pg8::gemm_phase<EpiRes, pg8::StaticOrder, PG8_ALIGN, PG8_SP2>(ldsl + RING_OFF, g, S, E); } SEAM(3);
    if (IN(4)) { norm_phase<false>(P.out, P.out + (size_t)NPR * DM, P.norm_g + DM, P.modv, 3, 4, P.H, nullptr, gw, NGW, lane); } SEAM(4);
    if (IN(5)) { pg8::Gemm g{P.H, P.Win, NTOK, DIN, DM}; pg8::StaticOrder S; S.init(NTOK, DIN, G, bx);
        EpiProj E{P.Q, P.KB, P.VB, P.XR, P.XG, P.out_k, P.out_v, P.tab + TAB_COS, P.tab + TAB_SIN};
        pg8::gemm_phase<EpiProj, pg8::StaticOrder, PG8_ALIGN, PG8_SP2>(ldsl + RING_OFF, g, S, E); } SEAM(5);
    if (IN(6)) {
        float lam; { const float a = P.diff_lambda[lane] * P.diff_lambda[64 + lane], b2 = P.diff_lambda[128 + lane] * P.diff_lambda[192 + lane];
                     lam = expf(wave_sum(a)) - expf(wave_sum(b2)) + 0.2f; }
        for (int i = vcu; i < 512; i += G) {
            if (i < 256) { const int bh = i >> 5, qb = i & 31, b = bh >> 2, h = bh & 3; const size_t qrow = (size_t)NPR + (size_t)b * SEQS + qb * 128, krow = (size_t)NPR + (size_t)b * SKVS;
                att::attn_unit(P.Q + qrow * DH + h * 128, P.KB + krow * DH + h * 128, P.VB + krow * DH + h * 128, P.MIX + qrow * 1024 + h * 128, SKVS, lam, P.subln_g, (char*)lds + RING_OFF); }
            else { const int j = i - 256, b = j >> 3, h = (j >> 1) & 3, qb = j & 1; const size_t qrow = (size_t)b * SEQP + qb * 128, krow = (size_t)b * SEQP;
                att::attn_unit(P.Q + qrow * DH + h * 128, P.KB + krow * DH + h * 128, P.VB + krow * DH + h * 128, P.MIX + qrow * 1024 + h * 128, SEQP, lam, P.subln_g, (char*)lds + RING_OFF); }
        }
        for (int i = vcu; i < 1024; i += G)
            rgl::rg_unit<false>(i >> 3, i & 7, P.XR, P.XG, P.Wrg, P.conv_w, P.conv_b, P.rg_b_r, P.rg_b_i, P.tab + TAB_SP, P.state, P.comp, P.MIX, P.out_state, (char*)lds + RING_OFF);
    } SEAM(6);
    if (IN(7)) {
        for (int i = vcu; i < 1024; i += G)
            rgl::rg_unit<true>(i >> 3, i & 7, P.XR, P.XG, P.Wrg, P.conv_w, P.conv_b, P.rg_b_r, P.rg_b_i, P.tab + TAB_SP, P.state, P.comp, P.MIX, P.out_state, (char*)lds + RING_OFF);
    } SEAM(7);
    if (IN(8)) { pg8::Gemm g{P.MIX, P.Wout, NTOK, DM, DM}; pg8::StaticOrder S; S.init(NTOK, DM, G, bx); EpiRes E{P.out, P.out + (size_t)NPR * DM, P.out, P.modv, 5, 1.0f};
        pg8::gemm_phase<EpiRes, pg8::StaticOrder, PG8_ALIGN, PG8_SP2>(ldsl + RING_OFF, g, S, E); } SEAM(8);
    if (IN(9)) { norm_phase<false>(P.out, P.out + (size_t)NPR * DM, P.norm_g + 2 * DM, P.modv, 6, 7, P.H, nullptr, gw, NGW, lane); } SEAM(9);
    if (IN(10)) { pg8::Gemm g{P.H, P.Wgu2, NTOK, NGU, DM}; pg8::StaticOrder S; S.init(NTOK, NGU, G, bx); EpiSwiglu E{P.HID};
        pg8::gemm_phase<EpiSwiglu, pg8::StaticOrder, PG8_ALIGN, PG8_SP2>(ldsl + RING_OFF, g, S, E); } SEAM(10);
    if (IN(11)) { pg8::Gemm g{P.HID, P.Wd2, NTOK, DM, DFF}; pg8::StaticOrder S; S.init(NTOK, DM, G, bx); EpiRes E{P.out, P.out + (size_t)NPR * DM, P.out, P.modv, 8, 0.5f};
        pg8::gemm_phase<EpiRes, pg8::StaticOrder, PG8_ALIGN, PG8_SP2>(ldsl + RING_OFF, g, S, E); } SEAM(11);
    if (IN(12)) { norm_phase<true>(P.out, P.out + (size_t)NPR * DM, P.final_g, P.modv, 0, 0, nullptr, P.out, gw, NGW, lane); }
#undef IN
#undef SEAM
}

extern "C" void kernel_launch(void* const* d_in, const int* in_sizes, int n_in, void* d_out, int out_size, void* d_ws, size_t ws_size, hipStream_t stream) {
    static int grid = 0;
    if (grid == 0) {
        if (n_in != 25 || in_sizes[0] != NPR * DM || out_size != 2 * NPR * DM + 2 * NPR * DH + 32 * 1024 || ws_size < WS_END) {
            fprintf(stderr, "kernel_launch: unexpected shapes: n_in %d in0 %d out %d ws %zu\n", n_in, n_in > 0 ? in_sizes[0] : -1, out_size, ws_size); grid = -1; return; }
        int dev = 0, cus = 0;
        if (hipGetDevice(&dev) != hipSuccess || hipDeviceGetAttribute(&cus, hipDeviceAttributeMultiprocessorCount, dev) != hipSuccess) { fprintf(stderr, "kernel_launch: device query failed\n"); grid = -1; return; }
        if (hipFuncSetAttribute((const void*)fwd_kernel, hipFuncAttributeMaxDynamicSharedMemorySize, LDS_BYTES) != hipSuccess) { fprintf(stderr, "kernel_launch: hipFuncSetAttribute failed\n"); grid = -1; return; }
        int per_cu = 0;
        if (hipOccupancyMaxActiveBlocksPerMultiprocessor(&per_cu, (const void*)fwd_kernel, NWAVES * 64, LDS_BYTES) != hipSuccess || per_cu < 1)
            fprintf(stderr, "kernel_launch: note: occupancy query reports %d workgroups per CU\n", per_cu);
        (void)hipGetLastError();
        grid = cus;
    }
    if (grid < 0) return;
    if (hipMemsetAsync((char*)d_ws + WS_CTL, 0, CTL_ZERO_BYTES, stream) != hipSuccess) { fprintf(stderr, "kernel_launch: memset failed\n"); return; }
    Args a{};
    for (int i = 0; i < 25; ++i) a.in[i] = (const float*)d_in[i];
    a.out = (float*)d_out; a.ws = (unsigned char*)d_ws;
#if MK_PER_PHASE
    for (int p = 0; p < N_PHASES; ++p) { a.ph_lo = p; a.ph_hi = p + 1; hipLaunchKernelGGL(fwd_kernel, dim3(grid), dim3(NWAVES * 64), LDS_BYTES, stream, a); }
#else
    a.ph_lo = 0; a.ph_hi = N_PHASES; hipLaunchKernelGGL(fwd_kernel, dim3(grid), dim3(NWAVES * 64), LDS_BYTES, stream, a);
#endif
    const hipError_t le = hipPeekAtLastError();
    if (le != hipSuccess) fprintf(stderr, "kernel_launch: launch failed: %s\n", hipGetErrorName(le));
}
```
